# Optimizing an MI355X kernel written in HIP

```python
import math
import jax, jax.numpy as jnp
from jax import lax
import numpy as np

D_MODEL = 1024
BATCH = 8
SEQ = 2048
DEPTH = 1

CHUNK = 64
N_META = 16
Q_BLOCK = 128
FRONT_PAD = Q_BLOCK - N_META

GLA_HEADS = 4
GLA_DV = D_MODEL // 8
GLA_DK = GLA_DV // 2
GLA_GATE_RANK = 16
GLA_TAU = 16.0
DIFF_HEADS = 4
DIFF_DH = D_MODEL // 16
DIFF_DV = 2 * DIFF_DH
MIX_WIDTH = GLA_HEADS * GLA_DV + DIFF_HEADS * DIFF_DV

IN_SIZES = (GLA_HEADS * GLA_DK, GLA_HEADS * GLA_DK, GLA_HEADS * GLA_DV, GLA_HEADS * GLA_DV, GLA_GATE_RANK,
            DIFF_HEADS * 2 * DIFF_DH, DIFF_HEADS * 2 * DIFF_DH, DIFF_HEADS * DIFF_DV)
IN_WIDTH = sum(IN_SIZES)
IN_SPLIT_POINTS = tuple(int(c) for c in np.cumsum(IN_SIZES)[:-1])
VALUE_BLOCKS = (2, 7)

N_EXPERTS = 32
TOP_K = 4
D_FF = D_MODEL
SWIGLU_LIMIT = 7.0
SWIGLU_ALPHA = 1.702
MOE_BLOCK = 128

DEEPNORM_ALPHA = (2.0 * DEPTH) ** 0.25
DEEPNORM_BETA = (8.0 * DEPTH) ** -0.25
LN_EPS = 1e-5
NEG_INF = -1e30

kernel_name = "hymba_gla_diffattn_alibi_deepnorm_moe"


def layer_norm(x, g, b):
    xf = x.astype(jnp.float32)
    mu = jnp.mean(xf, axis=-1, keepdims=True)
    var = jnp.mean(jnp.square(xf - mu), axis=-1, keepdims=True)
    return ((xf - mu) * lax.rsqrt(var + LN_EPS) * g.astype(jnp.float32) + b.astype(jnp.float32)).astype(x.dtype)


def rms_norm(x, g):
    xf = x.astype(jnp.float32)
    ms = jnp.mean(jnp.square(xf), axis=-1, keepdims=True)
    return (xf * lax.rsqrt(ms + LN_EPS) * g.astype(jnp.float32)).astype(x.dtype)


def gla_mixer(q, k, v, r, a_lr, wa2, ba, norm_g, valid):
    B, Lp, _ = q.shape
    nc = Lp // CHUNK
    f32 = jnp.float32
    log_a = jax.nn.log_sigmoid((a_lr @ wa2 + ba).astype(f32)) / GLA_TAU
    log_a = jnp.where(valid[None, :, None], log_a, 0.0)

    def chunks(t, d):
        return t.reshape(B, nc, CHUNK, GLA_HEADS, d)

    qc = chunks(q.astype(f32) * GLA_DK ** -0.5, GLA_DK)
    kc = chunks(k.astype(f32), GLA_DK)
    vc = chunks(v.astype(f32), GLA_DV)
    cum = jnp.cumsum(chunks(log_a, GLA_DK), axis=2)
    tot = cum[:, :, -1]
    kdec = kc * jnp.exp(tot[:, :, None] - cum)
    upd = jnp.einsum('bnchk,bnchv->bnhkv', kdec, vc)

    def step(S, inp):
        d, u = inp
        S = jnp.exp(d)[..., None] * S + u
        return S, S

    S0 = jnp.zeros((B, GLA_HEADS, GLA_DK, GLA_DV), f32)
    _, states = lax.scan(step, S0, (jnp.moveaxis(tot, 1, 0), jnp.moveaxis(upd, 1, 0)))
    o = jnp.einsum('bnchk,nbhkv->bnchv', qc, states).reshape(B, Lp, GLA_HEADS, GLA_DV)
    o = rms_norm(o, norm_g) * jax.nn.silu(r.reshape(B, Lp, GLA_HEADS, GLA_DV).astype(f32))
    return o.reshape(B, Lp, GLA_HEADS * GLA_DV).astype(q.dtype)


def diff_attention(q, k, v, lq1, lk1, lq2, lk2, norm_g, valid, lambda_init):
    B, Lp, _ = q.shape
    f32 = jnp.float32
    q = q.reshape(B, Lp, DIFF_HEADS, 2, DIFF_DH)
    k = k.reshape(B, Lp, DIFF_HEADS, 2, DIFF_DH)
    v = v.reshape(B, Lp, DIFF_HEADS, DIFF_DV)
    lam = (jnp.exp(jnp.sum(lq1.astype(f32) * lk1.astype(f32)))
           - jnp.exp(jnp.sum(lq2.astype(f32) * lk2.astype(f32))) + lambda_init)
    slopes = 2.0 ** (-8.0 * jnp.arange(1, DIFF_HEADS + 1, dtype=f32) / DIFF_HEADS)
    pos = jnp.arange(Lp)
    chunk = pos // CHUNK
    scale = DIFF_DH ** -0.5
    outs = []
    for j in range(Lp // Q_BLOCK):
        qs, ke = j * Q_BLOCK, (j + 1) * Q_BLOCK
        s = jnp.einsum('bqhmd,bkhmd->bhmqk', q[:, qs:ke], k[:, :ke]).astype(f32) * scale
        dist = jnp.abs(pos[qs:ke, None] - pos[None, :ke]).astype(f32)
        bias = -slopes[:, None, None, None] * dist
        allowed = (chunk[None, :ke] <= chunk[qs:ke, None]) & valid[None, :ke]
        s = jnp.where(allowed, s + bias, NEG_INF)
        p = jax.nn.softmax(s, axis=-1)
        a = p[:, :, 0] - lam * p[:, :, 1]
        outs.append(jnp.einsum('bhqk,bkhv->bqhv', a.astype(v.dtype), v[:, :ke]))
    o = jnp.concatenate(outs, axis=1)
    o = rms_norm(o, norm_g) * (1.0 - lambda_init)
    return o.reshape(B, Lp, DIFF_HEADS * DIFF_DV).astype(v.dtype)


def moe_ffn(h, router_w, router_b, w_gate_up, b_gate_up, w_down, b_down):
    B, L, D = h.shape
    n_tok = B * L
    xt = h.reshape(n_tok, D)
    logits = (xt @ router_w + router_b).astype(jnp.float32)
    top_logit, top_idx = lax.top_k(logits, TOP_K)
    gates = jax.nn.softmax(top_logit, axis=-1).astype(h.dtype)
    n_assign = n_tok * TOP_K
    flat_e = top_idx.reshape(n_assign)
    order = jnp.argsort(flat_e)
    e_sorted = flat_e[order]
    tok_sorted = (order // TOP_K).astype(jnp.int32)
    counts = jnp.bincount(flat_e, length=N_EXPERTS)
    padded = (counts + MOE_BLOCK - 1) // MOE_BLOCK * MOE_BLOCK
    pad_end = jnp.cumsum(padded)
    pad_start = pad_end - padded
    grp_start = jnp.cumsum(counts) - counts
    dest = (pad_start[e_sorted] + jnp.arange(n_assign) - grp_start[e_sorted]).astype(jnp.int32)
    n_slots = -(-(n_assign + N_EXPERTS * (MOE_BLOCK - 1)) // MOE_BLOCK) * MOE_BLOCK
    n_blocks = n_slots // MOE_BLOCK
    src_tok = jnp.full((n_slots,), n_tok, jnp.int32).at[dest].set(tok_sorted)
    x_ext = jnp.concatenate([xt, jnp.zeros((1, D), h.dtype)], axis=0)
    x_blocks = x_ext[src_tok].reshape(n_blocks, MOE_BLOCK, D)
    block_expert = jnp.minimum(
        jnp.searchsorted(pad_end, jnp.arange(n_blocks) * MOE_BLOCK, side='right'), N_EXPERTS - 1)

    def expert_block(args):
        xb, e = args
        gu = xb @ w_gate_up[e] + b_gate_up[e]
        g = jnp.minimum(gu[:, 0::2], SWIGLU_LIMIT)
        u = jnp.clip(gu[:, 1::2], -SWIGLU_LIMIT, SWIGLU_LIMIT)
        glu = g * jax.nn.sigmoid(SWIGLU_ALPHA * g)
        return ((u + 1.0) * glu) @ w_down[e] + b_down[e]

    y_slots = lax.map(expert_block, (x_blocks, block_expert)).reshape(n_slots, D)
    slot = jnp.zeros((n_assign,), jnp.int32).at[order].set(dest)
    y = jnp.sum(y_slots[slot].reshape(n_tok, TOP_K, D) * gates[..., None], axis=1)
    return y.reshape(B, L, D)


def setup_inputs(seed: int = 0) -> dict:
    key = jax.random.key(seed)
    ks = jax.random.split(key, 24)
    f32 = jnp.float32

    def nrm(k, shape, s):
        return jax.random.normal(k, shape, f32) * s

    in_keys = jax.random.split(ks[3], len(IN_SIZES))
    w_in = jnp.concatenate(
        [nrm(in_keys[i], (DEPTH, D_MODEL, n), D_MODEL ** -0.5 * (DEEPNORM_BETA if i in VALUE_BLOCKS else 1.0))
         for i, n in enumerate(IN_SIZES)], axis=-1)
    return {
        "x": nrm(ks[0], (BATCH, SEQ, D_MODEL), 1.0),
        "meta_tokens": nrm(ks[1], (N_META, D_MODEL), 1.0),
        "ln_emb_g": 1.0 + nrm(ks[2], (D_MODEL,), 0.01),
        "ln_emb_b": nrm(ks[4], (D_MODEL,), 0.01),
        "w_in": w_in,
        "gla_wa2": nrm(ks[5], (DEPTH, GLA_GATE_RANK, GLA_HEADS * GLA_DK), GLA_GATE_RANK ** -0.5),
        "gla_ba": nrm(ks[6], (DEPTH, GLA_HEADS * GLA_DK), 0.1),
        "gla_norm_g": 1.0 + nrm(ks[7], (DEPTH, GLA_DV), 0.01),
        "diff_lambda_q1": nrm(ks[8], (DEPTH, DIFF_DH), 0.1),
        "diff_lambda_k1": nrm(ks[9], (DEPTH, DIFF_DH), 0.1),
        "diff_lambda_q2": nrm(ks[10], (DEPTH, DIFF_DH), 0.1),
        "diff_lambda_k2": nrm(ks[11], (DEPTH, DIFF_DH), 0.1),
        "diff_norm_g": 1.0 + nrm(ks[12], (DEPTH, DIFF_DV), 0.01),
        "w_out": nrm(ks[13], (DEPTH, MIX_WIDTH, D_MODEL), MIX_WIDTH ** -0.5 * DEEPNORM_BETA),
        "ln1_g": 1.0 + nrm(ks[14], (DEPTH, D_MODEL), 0.01),
        "ln1_b": nrm(ks[15], (DEPTH, D_MODEL), 0.01),
        "router_w": nrm(ks[16], (DEPTH, D_MODEL, N_EXPERTS), D_MODEL ** -0.5),
        "router_b": nrm(ks[17], (DEPTH, N_EXPERTS), 0.01),
        "w_gate_up": nrm(ks[18], (DEPTH, N_EXPERTS, D_MODEL, 2 * D_FF), D_MODEL ** -0.5 * DEEPNORM_BETA),
        "b_gate_up": nrm(ks[19], (DEPTH, N_EXPERTS, 2 * D_FF), 0.01),
        "w_down": nrm(ks[20], (DEPTH, N_EXPERTS, D_FF, D_MODEL), D_FF ** -0.5 * DEEPNORM_BETA),
        "b_down": nrm(ks[21], (DEPTH, N_EXPERTS, D_MODEL), 0.01),
        "ln2_g": 1.0 + nrm(ks[22], (DEPTH, D_MODEL), 0.01),
        "ln2_b": nrm(ks[23], (DEPTH, D_MODEL), 0.01),
    }


def reference(x, meta_tokens, ln_emb_g, ln_emb_b, w_in, gla_wa2, gla_ba, gla_norm_g,
              diff_lambda_q1, diff_lambda_k1, diff_lambda_q2, diff_lambda_k2, diff_norm_g,
              w_out, ln1_g, ln1_b, router_w, router_b, w_gate_up, b_gate_up, w_down, b_down,
              ln2_g, ln2_b):
    B = x.shape[0]
    meta = jnp.broadcast_to(meta_tokens[None].astype(x.dtype), (B, N_META, D_MODEL))
    h = layer_norm(jnp.concatenate([meta, x], axis=1), ln_emb_g, ln_emb_b)
    Lp = h.shape[1] + FRONT_PAD
    valid = jnp.arange(Lp) >= FRONT_PAD
    for l in range(DEPTH):
        lambda_init = 0.8 - 0.6 * math.exp(-0.3 * l)
        proj = jnp.pad(h @ w_in[l], ((0, 0), (FRONT_PAD, 0), (0, 0)))
        gq, gk, gv, gr, ga, dq, dk, dv = jnp.split(proj, IN_SPLIT_POINTS, axis=-1)
        o_gla = gla_mixer(gq, gk, gv, gr, ga, gla_wa2[l], gla_ba[l], gla_norm_g[l], valid)
        o_diff = diff_attention(dq, dk, dv, diff_lambda_q1[l], diff_lambda_k1[l], diff_lambda_q2[l],
                                diff_lambda_k2[l], diff_norm_g[l], valid, lambda_init)
        mix = jnp.concatenate([o_gla, o_diff], axis=-1)[:, FRONT_PAD:] @ w_out[l]
        h = layer_norm(DEEPNORM_ALPHA * h + mix, ln1_g[l], ln1_b[l])
        ffn = moe_ffn(h, router_w[l], router_b[l], w_gate_up[l], b_gate_up[l], w_down[l], b_down[l])
        h = layer_norm(DEEPNORM_ALPHA * h + ffn, ln2_g[l], ln2_b[l])
    return h[:, N_META:]
```

```cpp
#include <hip/hip_runtime.h>
#include <cstdint>
#include <cstdio>

namespace nv {
constexpr int B = 8, SEQ = 2048, D = 1024, NMETA = 16;
constexpr int T = B * SEQ;
constexpr int NR = T + NMETA;
constexpr int INW = 3088;
constexpr int C_GQ = 0, C_GK = 256, C_GV = 512, C_GR = 1024, C_GA = 1536, C_DQ = 1552, C_DK = 2064, C_DV = 2576;
constexpr int NE = 32, TOPK = 4, NASSIGN = T * TOPK;
constexpr int SLOT_PAD = 64;
constexpr int NSLOT_MAX = NASSIGN + NE * SLOT_PAD;
constexpr float ALPHA = 1.189207115002721f;
constexpr float LN_EPS = 1e-5f;

__device__ __forceinline__ float wave_sum(float v) {
#pragma unroll
    for (int o = 32; o >= 1; o >>= 1) v += __shfl_xor(v, o);
    return v;
}
__device__ __forceinline__ float wave_max(float v) {
#pragma unroll
    for (int o = 32; o >= 1; o >>= 1) v = fmaxf(v, __shfl_xor(v, o));
    return v;
}

__global__ void __launch_bounds__(256) ln_rows(const float* __restrict__ x, const float* __restrict__ meta, const float* __restrict__ add, float alpha,
                                               const float* __restrict__ g, const float* __restrict__ bb, float* __restrict__ out, int nrows) {
    const int row = blockIdx.x * 4 + (threadIdx.x >> 6), lane = threadIdx.x & 63;
    if (row >= nrows) return;
    const float* src = row < T ? x + (size_t)row * D : meta + (size_t)(row - T) * D;
    float v[16]; float s = 0.f;
#pragma unroll
    for (int j = 0; j < 16; ++j) { v[j] = src[j * 64 + lane]; if (add) v[j] = alpha * v[j] + add[(size_t)row * D + j * 64 + lane]; s += v[j]; }
    const float mean = wave_sum(s) * (1.f / D); float q = 0.f;
#pragma unroll
    for (int j = 0; j < 16; ++j) { v[j] -= mean; q += v[j] * v[j]; }
    const float rstd = rsqrtf(wave_sum(q) * (1.f / D) + LN_EPS);
#pragma unroll
    for (int j = 0; j < 16; ++j) out[(size_t)row * D + j * 64 + lane] = v[j] * rstd * g[j * 64 + lane] + bb[j * 64 + lane];
}

template <int MODE>
__global__ void __launch_bounds__(256) gemm64(const float* __restrict__ A, int lda, const float* __restrict__ Bm, int ldb, float* __restrict__ C, int ldc,
                                              int M, int N, int K, const int* __restrict__ cnt, const int* __restrict__ pad_start, const int* __restrict__ src_tok,
                                              const float* __restrict__ bias, long strideB, long strideBias) {
    __shared__ float As[16][65];
    __shared__ float Bs[16][65];
    const int tid = threadIdx.x, tx = tid & 15, ty = tid >> 4;
    int m0 = blockIdx.y * 64; const int n0 = blockIdx.x * 64;
    int rows = M, rbase = 0;
    if (MODE != 0) { const int e = blockIdx.z; rows = cnt[e]; if (m0 >= rows) return; rbase = pad_start[e]; Bm += (size_t)e * strideB; bias += (size_t)e * strideBias; }
    const int ar = tid >> 2, ak = (tid & 3) * 4;
    const float* arow = nullptr;
    { const int r = m0 + ar; if (r < rows) { long gr = (MODE == 0) ? r : (MODE == 1 ? src_tok[rbase + r] : rbase + r); arow = A + (size_t)gr * lda; } }
    const int bk = tid >> 4, bn = (tid & 15) * 4;
    float acc[4][4];
#pragma unroll
    for (int i = 0; i < 4; ++i)
#pragma unroll
        for (int j = 0; j < 4; ++j) acc[i][j] = 0.f;
    for (int k0 = 0; k0 < K; k0 += 16) {
        float4 av = make_float4(0.f, 0.f, 0.f, 0.f);
        if (arow) av = *(const float4*)(arow + k0 + ak);
        As[ak + 0][ar] = av.x; As[ak + 1][ar] = av.y; As[ak + 2][ar] = av.z; As[ak + 3][ar] = av.w;
#pragma unroll
        for (int j = 0; j < 4; ++j) { const int n = n0 + bn + j; Bs[bk][bn + j] = (n < N) ? Bm[(size_t)(k0 + bk) * ldb + n] : 0.f; }
        __syncthreads();
#pragma unroll
        for (int kk = 0; kk < 16; ++kk) {
            float a[4], b[4];
#pragma unroll
            for (int i = 0; i < 4; ++i) a[i] = As[kk][ty * 4 + i];
#pragma unroll
            for (int j = 0; j < 4; ++j) b[j] = Bs[kk][tx * 4 + j];
#pragma unroll
            for (int i = 0; i < 4; ++i)
#pragma unroll
                for (int j = 0; j < 4; ++j) acc[i][j] = fmaf(a[i], b[j], acc[i][j]);
        }
        __syncthreads();
    }
#pragma unroll
    for (int i = 0; i < 4; ++i) {
        const int r = m0 + ty * 4 + i; if (r >= rows) continue;
        const long orow = (MODE == 0) ? r : rbase + r;
        if (MODE == 1) {
#pragma unroll
            for (int j = 0; j < 4; j += 2) { const int n = n0 + tx * 4 + j;
                float gg = acc[i][j] + bias[n], uu = acc[i][j + 1] + bias[n + 1];
                gg = fminf(gg, 7.0f); uu = fminf(fmaxf(uu, -7.0f), 7.0f);
                const float glu = gg * (1.f / (1.f + __expf(-1.702f * gg)));
                C[(size_t)orow * ldc + (n >> 1)] = (uu + 1.0f) * glu; }
        } else {
#pragma unroll
            for (int j = 0; j < 4; ++j) { const int n = n0 + tx * 4 + j; if (n < N) C[(size_t)orow * ldc + n] = acc[i][j] + (MODE == 2 ? bias[n] : 0.f); }
        }
    }
}

__global__ void __launch_bounds__(256) gla_loga(const float* __restrict__ proj, const float* __restrict__ wa2, const float* __restrict__ ba, float* __restrict__ la) {
    const int row = blockIdx.x, c = threadIdx.x;
    float s = ba[c];
#pragma unroll
    for (int j = 0; j < 16; ++j) s = fmaf(proj[(size_t)row * INW + C_GA + j], wa2[j * 256 + c], s);
    const float ls = fminf(s, 0.f) - log1pf(__expf(-fabsf(s)));
    la[(size_t)row * 256 + c] = ls * (1.f / 16.f);
}

__global__ void __launch_bounds__(256) gla_naive(const float* __restrict__ proj, const float* __restrict__ la, const float* __restrict__ norm_g, float* __restrict__ mix) {
    extern __shared__ float sm[];
    float* S = sm;
    float* kd = S + 64 * 128;
    float* vv = kd + 64 * 64;
    float* qq = vv + 64 * 128;
    float* cum = qq + 64 * 64;
    float* ob = cum + 64 * 64;
    const int b = blockIdx.x >> 2, h = blockIdx.x & 3, tid = threadIdx.x;
    for (int i = tid; i < 64 * 128; i += 256) S[i] = 0.f;
    __syncthreads();
    for (int c = -1; c < 32; ++c) {
        const int nt = c < 0 ? 16 : 64;
        const long row0 = c < 0 ? T : (long)b * SEQ + c * 64;
        for (int i = tid; i < nt * 64; i += 256) { const int t = i >> 6, k = i & 63; const size_t r = (size_t)(row0 + t);
            cum[i] = la[r * 256 + h * 64 + k]; kd[i] = proj[r * INW + C_GK + h * 64 + k]; qq[i] = proj[r * INW + C_GQ + h * 64 + k] * 0.125f; }
        for (int i = tid; i < nt * 128; i += 256) { const int t = i >> 7, v = i & 127; vv[i] = proj[(size_t)(row0 + t) * INW + C_GV + h * 128 + v]; }
        __syncthreads();
        if (tid < 64) { float s = 0.f; for (int t = 0; t < nt; ++t) { s += cum[t * 64 + tid]; cum[t * 64 + tid] = s; } }
        __syncthreads();
        for (int i = tid; i < nt * 64; i += 256) { const int k = i & 63; kd[i] *= __expf(cum[(nt - 1) * 64 + k] - cum[i]); }
        __syncthreads();
        for (int i = tid; i < 64 * 128; i += 256) { const int k = i >> 7, v = i & 127; float s = __expf(cum[(nt - 1) * 64 + k]) * S[i];
            for (int t = 0; t < nt; ++t) s = fmaf(kd[t * 64 + k], vv[t * 128 + v], s);
            S[i] = s; }
        __syncthreads();
        if (c >= 0) {
            for (int i = tid; i < 64 * 128; i += 256) { const int t = i >> 7, v = i & 127; float s = 0.f;
                for (int k = 0; k < 64; ++k) s = fmaf(qq[t * 64 + k], S[k * 128 + v], s);
                ob[i] = s; }
            __syncthreads();
            const int lane = tid & 63, w = tid >> 6;
            for (int t = w; t < 64; t += 4) { const float a0 = ob[t * 128 + lane], a1 = ob[t * 128 + 64 + lane];
                const float ms = wave_sum(a0 * a0 + a1 * a1) * (1.f / 128.f); const float rs = rsqrtf(ms + LN_EPS);
                const size_t r = (size_t)(row0 + t);
                const float r0 = proj[r * INW + C_GR + h * 128 + lane], r1 = proj[r * INW + C_GR + h * 128 + 64 + lane];
                mix[r * D + h * 128 + lane] = a0 * rs * norm_g[lane] * (r0 / (1.f + __expf(-r0)));
                mix[r * D + h * 128 + 64 + lane] = a1 * rs * norm_g[64 + lane] * (r1 / (1.f + __expf(-r1))); }
        }
        __syncthreads();
    }
}

__global__ void __launch_bounds__(256) diff_naive(const float* __restrict__ proj, const float* __restrict__ lq1, const float* __restrict__ lk1, const float* __restrict__ lq2,
                                                  const float* __restrict__ lk2, const float* __restrict__ norm_g, float* __restrict__ mix) {
    extern __shared__ float sm[];
    const int w = threadIdx.x >> 6, lane = threadIdx.x & 63;
    float* sc0 = sm + w * (2 * 2112 + 128); float* sc1 = sc0 + 2112; float* qs = sc1 + 2112;
    const int qi = blockIdx.x * 4 + w;
    const int f = qi & 2047, h = (qi >> 11) & 3, b = qi >> 13;
    const size_t qrow = (size_t)b * SEQ + f;
    qs[lane] = proj[qrow * INW + C_DQ + h * 128 + lane]; qs[64 + lane] = proj[qrow * INW + C_DQ + h * 128 + 64 + lane];
    float lam;
    { const float a = wave_sum(lq1[lane] * lk1[lane]), c = wave_sum(lq2[lane] * lk2[lane]); lam = __expf(a) - __expf(c) + 0.2f; }
    const float slope = exp2f(-2.0f * (float)(h + 1));
    const int nk = 16 + ((f >> 6) + 1) * 64;
    float m0 = -1e30f, m1 = -1e30f;
    for (int kk = lane; kk < nk; kk += 64) {
        const size_t krow = kk < 16 ? (size_t)(T + kk) : (size_t)b * SEQ + (kk - 16);
        const float dist = fabsf((float)(f - (kk - 16)));
        const float* kp = proj + krow * INW + C_DK + h * 128;
        float s0 = 0.f, s1 = 0.f;
        for (int d = 0; d < 64; d += 4) { const float4 k0 = *(const float4*)(kp + d), k1 = *(const float4*)(kp + 64 + d);
            s0 += qs[d] * k0.x + qs[d + 1] * k0.y + qs[d + 2] * k0.z + qs[d + 3] * k0.w;
            s1 += qs[64 + d] * k1.x + qs[64 + d + 1] * k1.y + qs[64 + d + 2] * k1.z + qs[64 + d + 3] * k1.w; }
        s0 = s0 * 0.125f - slope * dist; s1 = s1 * 0.125f - slope * dist;
        sc0[kk] = s0; sc1[kk] = s1; m0 = fmaxf(m0, s0); m1 = fmaxf(m1, s1);
    }
    m0 = wave_max(m0); m1 = wave_max(m1);
    float l0 = 0.f, l1 = 0.f;
    for (int kk = lane; kk < nk; kk += 64) { const float p0 = __expf(sc0[kk] - m0), p1 = __expf(sc1[kk] - m1); sc0[kk] = p0; sc1[kk] = p1; l0 += p0; l1 += p1; }
    l0 = wave_sum(l0); l1 = wave_sum(l1);
    const float i0 = 1.f / l0, i1 = lam / l1;
    for (int kk = lane; kk < nk; kk += 64) sc0[kk] = sc0[kk] * i0 - sc1[kk] * i1;
    __builtin_amdgcn_s_waitcnt(0); __builtin_amdgcn_wave_barrier();
    float o0 = 0.f, o1 = 0.f;
    for (int kk = 0; kk < nk; ++kk) {
        const size_t krow = kk < 16 ? (size_t)(T + kk) : (size_t)b * SEQ + (kk - 16);
        const float a = sc0[kk]; const float* vp = proj + krow * INW + C_DV + h * 128;
        o0 = fmaf(a, vp[lane], o0); o1 = fmaf(a, vp[64 + lane], o1);
    }
    const float ms = wave_sum(o0 * o0 + o1 * o1) * (1.f / 128.f); const float rs = rsqrtf(ms + LN_EPS) * 0.8f;
    mix[qrow * D + 512 + h * 128 + lane] = o0 * rs * norm_g[lane];
    mix[qrow * D + 512 + h * 128 + 64 + lane] = o1 * rs * norm_g[64 + lane];
}

__global__ void __launch_bounds__(256) router_naive(const float* __restrict__ h1, const float* __restrict__ rw, const float* __restrict__ rb, int* __restrict__ cnt,
                                                    int* __restrict__ tok_e, int* __restrict__ tok_rank, float* __restrict__ tok_gate) {
    const int tok = blockIdx.x * 4 + (threadIdx.x >> 6), lane = threadIdx.x & 63;
    const int e = lane & 31, half = lane >> 5;
    const float* hp = h1 + (size_t)tok * D + half * 512;
    const float* wp = rw + (size_t)(half * 512) * NE + e;
    float acc = 0.f;
    for (int k = 0; k < 512; ++k) acc = fmaf(hp[k], wp[(size_t)k * NE], acc);
    acc += __shfl_xor(acc, 32);
    float logit = acc + rb[e];
    float cur = logit; float tl[4]; int ti[4];
#pragma unroll
    for (int r = 0; r < 4; ++r) {
        float mv = cur; int mi = e;
#pragma unroll
        for (int o = 16; o >= 1; o >>= 1) { const float ov = __shfl_xor(mv, o); const int oi = __shfl_xor(mi, o); if (ov > mv || (ov == mv && oi < mi)) { mv = ov; mi = oi; } }
        tl[r] = mv; ti[r] = mi; if (e == mi) cur = -3.0e38f;
    }
    const float mx = tl[0]; float ex[4], s = 0.f;
#pragma unroll
    for (int r = 0; r < 4; ++r) { ex[r] = __expf(tl[r] - mx); s += ex[r]; }
    if (lane < 4) { int r = lane; const int ee = r == 0 ? ti[0] : r == 1 ? ti[1] : r == 2 ? ti[2] : ti[3]; const float gg = (r == 0 ? ex[0] : r == 1 ? ex[1] : r == 2 ? ex[2] : ex[3]) / s;
        const int rank = atomicAdd(&cnt[ee], 1); tok_e[tok * 4 + r] = ee; tok_rank[tok * 4 + r] = rank; tok_gate[tok * 4 + r] = gg; }
}
__global__ void moe_offsets(const int* __restrict__ cnt, int* __restrict__ pad_start) {
    if (threadIdx.x == 0) { int s = 0; for (int e = 0; e < NE; ++e) { pad_start[e] = s; s += (cnt[e] + SLOT_PAD - 1) / SLOT_PAD * SLOT_PAD; } pad_start[NE] = s; }
}
__global__ void __launch_bounds__(256) moe_fill(const int* __restrict__ tok_e, const int* __restrict__ tok_rank, const int* __restrict__ pad_start, int* __restrict__ src_tok, int* __restrict__ slot_of) {
    const int i = blockIdx.x * 256 + threadIdx.x; if (i >= NASSIGN) return;
    const int slot = pad_start[tok_e[i]] + tok_rank[i]; src_tok[slot] = i >> 2; slot_of[i] = slot;
}
__global__ void __launch_bounds__(256) final_naive(const float* __restrict__ h1, const float* __restrict__ y, const int* __restrict__ slot_of, const float* __restrict__ tok_gate,
                                                   const float* __restrict__ g, const float* __restrict__ bb, float* __restrict__ out) {
    const int tok = blockIdx.x * 4 + (threadIdx.x >> 6), lane = threadIdx.x & 63;
    int sl[4]; float gt[4];
#pragma unroll
    for (int r = 0; r < 4; ++r) { sl[r] = slot_of[tok * 4 + r]; gt[r] = tok_gate[tok * 4 + r]; }
    float v[16]; float s = 0.f;
#pragma unroll
    for (int j = 0; j < 16; ++j) { const int c = j * 64 + lane; float f = 0.f;
#pragma unroll
        for (int r = 0; r < 4; ++r) f += y[(size_t)sl[r] * D + c] * gt[r];
        v[j] = ALPHA * h1[(size_t)tok * D + c] + f; s += v[j]; }
    const float mean = wave_sum(s) * (1.f / D); float q = 0.f;
#pragma unroll
    for (int j = 0; j < 16; ++j) { v[j] -= mean; q += v[j] * v[j]; }
    const float rstd = rsqrtf(wave_sum(q) * (1.f / D) + LN_EPS);
#pragma unroll
    for (int j = 0; j < 16; ++j) { const int c = j * 64 + lane; out[(size_t)tok * D + c] = v[j] * rstd * g[c] + bb[c]; }
}
}

extern "C" void kernel_launch(void* const* d_in, const int* in_sizes, int n_in, void* d_out, int out_size, void* d_ws, size_t ws_size, hipStream_t stream) {
    using namespace nv;
    const float* x = (const float*)d_in[0]; const float* meta = (const float*)d_in[1]; const float* ln_emb_g = (const float*)d_in[2]; const float* ln_emb_b = (const float*)d_in[3];
    const float* w_in = (const float*)d_in[4]; const float* wa2 = (const float*)d_in[5]; const float* ba = (const float*)d_in[6]; const float* gla_norm_g = (const float*)d_in[7];
    const float* lq1 = (const float*)d_in[8]; const float* lk1 = (const float*)d_in[9]; const float* lq2 = (const float*)d_in[10]; const float* lk2 = (const float*)d_in[11];
    const float* diff_norm_g = (const float*)d_in[12]; const float* w_out = (const float*)d_in[13]; const float* ln1_g = (const float*)d_in[14]; const float* ln1_b = (const float*)d_in[15];
    const float* router_w = (const float*)d_in[16]; const float* router_b = (const float*)d_in[17]; const float* w_gate_up = (const float*)d_in[18]; const float* b_gate_up = (const float*)d_in[19];
    const float* w_down = (const float*)d_in[20]; const float* b_down = (const float*)d_in[21]; const float* ln2_g = (const float*)d_in[22]; const float* ln2_b = (const float*)d_in[23];
    float* out = (float*)d_out;
    char* ws = (char*)d_ws; size_t off = 0;
    auto take = [&](size_t bytes) { char* p = ws + off; off += (bytes + 255) & ~(size_t)255; return p; };
    float* h0 = (float*)take((size_t)NR * D * 4); float* proj = (float*)take((size_t)NR * INW * 4); float* la = (float*)take((size_t)NR * 256 * 4);
    float* act = h0;
    float* mix = (float*)take((size_t)T * D * 4); float* mixp = (float*)take((size_t)T * D * 4); float* h1 = (float*)take((size_t)T * D * 4);
    float* y = (float*)take((size_t)NSLOT_MAX * D * 4);
    int* cnt = (int*)take(256); int* pad_start = (int*)take(256); int* tok_e = (int*)take(NASSIGN * 4); int* tok_rank = (int*)take(NASSIGN * 4); float* tok_gate = (float*)take(NASSIGN * 4);
    int* src_tok = (int*)take(NSLOT_MAX * 4); int* slot_of = (int*)take(NASSIGN * 4);
    if (off > ws_size || (size_t)NSLOT_MAX * D * 4 > (size_t)((char*)mix - (char*)h0)) { fprintf(stderr, "kernel_launch: workspace too small (%zu needed, %zu given)\n", off, ws_size); return; }
    hipMemsetAsync(cnt, 0, 256, stream);
    ln_rows<<<NR / 4, 256, 0, stream>>>(x, meta, nullptr, 0.f, ln_emb_g, ln_emb_b, h0, NR);
    gemm64<0><<<dim3((INW + 63) / 64, (NR + 63) / 64, 1), 256, 0, stream>>>(h0, D, w_in, INW, proj, INW, NR, INW, D, nullptr, nullptr, nullptr, nullptr, 0, 0);
    gla_loga<<<NR, 256, 0, stream>>>(proj, wa2, ba, la);
    static bool attr_done = false;
    { const int smem = (64 * 128 * 3 + 64 * 64 * 3) * 4; if (!attr_done) hipFuncSetAttribute((const void*)gla_naive, hipFuncAttributeMaxDynamicSharedMemorySize, smem);
      gla_naive<<<B * 4, 256, smem, stream>>>(proj, la, gla_norm_g, mix); }
    { const int smem = 4 * (2 * 2112 + 128) * 4; if (!attr_done) hipFuncSetAttribute((const void*)diff_naive, hipFuncAttributeMaxDynamicSharedMemorySize, smem);
      diff_naive<<<B * 4 * SEQ / 4, 256, smem, stream>>>(proj, lq1, lk1, lq2, lk2, diff_norm_g, mix); attr_done = true; }
    gemm64<0><<<dim3(D / 64, T / 64, 1), 256, 0, stream>>>(mix, D, w_out, D, mixp, D, T, D, D, nullptr, nullptr, nullptr, nullptr, 0, 0);
    ln_rows<<<T / 4, 256, 0, stream>>>(h0, nullptr, mixp, ALPHA, ln1_g, ln1_b, h1, T);
    router_naive<<<T / 4, 256, 0, stream>>>(h1, router_w, router_b, cnt, tok_e, tok_rank, tok_gate);
    moe_offsets<<<1, 64, 0, stream>>>(cnt, pad_start);
    moe_fill<<<NASSIGN / 256, 256, 0, stream>>>(tok_e, tok_rank, pad_start, src_tok, slot_of);
    gemm64<1><<<dim3(2048 / 64, T / 64, NE), 256, 0, stream>>>(h1, D, w_gate_up, 2048, act, D, 0, 2048, D, cnt, pad_start, src_tok, b_gate_up, (long)D * 2048, 2048);
    gemm64<2><<<dim3(D / 64, T / 64, NE), 256, 0, stream>>>(act, D, w_down, D, y, D, 0, D, D, cnt, pad_start, src_tok, b_down, (long)D * D, D);
    final_naive<<<T / 4, 256, 0, stream>>>(h1, y, slot_of, tok_gate, ln2_g, ln2_b, out);
}
```
